# Optimizing an MI355X kernel written in HIP

```python
import functools
import jax, jax.numpy as jnp
from jax import lax
import numpy as np

D_MODEL = 1024
BATCH = 4
SEQ = 8192
DEPTH = 1
DEC_BATCH = 32
DEC_SEQ = 32
PAST_LEN = 1024

CHUNK = 64
D_CONV = 512
CONV_WIDTH = 31
N_Q_HEADS = 8
N_KV_HEADS = 2
HEAD_DIM = 64
GROUP = N_Q_HEADS // N_KV_HEADS
D_ATTN = N_Q_HEADS * HEAD_DIM
D_KV = N_KV_HEADS * HEAD_DIM
WINDOW = 128
WIN_CHUNKS = WINDOW // CHUNK
D_MIX = D_CONV + D_ATTN
D_IN = 2 * D_CONV + D_ATTN + 2 * D_KV
D_FF = 2816
FFN_CONV_WIDTH = 3
EPS = 1e-6
NEG_INF = -1e30

kernel_name = 'hymba_conformer_swa_sink_convffn_step'


def rmsnorm(x, g):
    x32 = x.astype(jnp.float32)
    y = x32 * lax.rsqrt(jnp.mean(x32 * x32, axis=-1, keepdims=True) + EPS)
    return y.astype(x.dtype) * g


def layernorm(x, g, b):
    x32 = x.astype(jnp.float32)
    mu = jnp.mean(x32, axis=-1, keepdims=True)
    xc = x32 - mu
    y = xc * lax.rsqrt(jnp.mean(xc * xc, axis=-1, keepdims=True) + EPS)
    return y.astype(x.dtype) * g + b


def causal_dwconv(x, hist, w, b):
    width = w.shape[0]
    xp = jnp.concatenate([hist.astype(x.dtype), x], axis=1)
    y = lax.conv_general_dilated(xp, w[:, None, :].astype(x.dtype), window_strides=(1,), padding='VALID',
                                 dimension_numbers=('NWC', 'WIO', 'NWC'), feature_group_count=x.shape[-1])
    return y + b, xp[:, -(width - 1):]


def sink_attention(q, k, v, sinks, key_valid):
    s = jnp.einsum('bcqhgd,bckhd->bchgqk', q, k).astype(jnp.float32) * (HEAD_DIM ** -0.5)
    if key_valid is not None:
        s = jnp.where(key_valid[None, :, None, None, None, :], s, NEG_INF)
    sink = sinks.astype(jnp.float32).reshape(1, 1, N_KV_HEADS, GROUP, 1, 1)
    m = jnp.maximum(jnp.max(s, axis=-1, keepdims=True), sink)
    p = jnp.exp(s - m)
    denom = jnp.sum(p, axis=-1, keepdims=True) + jnp.exp(sink - m)
    return jnp.einsum('bchgqk,bckhd->bcqhgd', (p / denom).astype(v.dtype), v)


def attn_prompt(q, k, v, sinks):
    b, s = q.shape[0], q.shape[1]
    n_c = s // CHUNK
    qc = q.reshape(b, n_c, CHUNK, N_KV_HEADS, GROUP, HEAD_DIM)
    pad = ((0, 0), (WIN_CHUNKS * CHUNK, 0), (0, 0), (0, 0))
    kp = jnp.pad(k, pad).reshape(b, n_c + WIN_CHUNKS, CHUNK, N_KV_HEADS, HEAD_DIM)
    vp = jnp.pad(v, pad).reshape(b, n_c + WIN_CHUNKS, CHUNK, N_KV_HEADS, HEAD_DIM)
    kb = jnp.concatenate([kp[:, i:i + n_c] for i in range(WIN_CHUNKS + 1)], axis=2)
    vb = jnp.concatenate([vp[:, i:i + n_c] for i in range(WIN_CHUNKS + 1)], axis=2)
    key_chunk = jnp.arange(n_c)[:, None] - WIN_CHUNKS + (jnp.arange((WIN_CHUNKS + 1) * CHUNK) // CHUNK)[None, :]
    o = sink_attention(qc, kb, vb, sinks, key_chunk >= 0)
    return o.reshape(b, s, D_ATTN), k[:, -WINDOW:], v[:, -WINDOW:]


def attn_sample(q, k, v, sinks, k_hist, v_hist):
    b, t = q.shape[0], q.shape[1]
    k_all = jnp.concatenate([k_hist.astype(k.dtype), k], axis=1)
    v_all = jnp.concatenate([v_hist.astype(v.dtype), v], axis=1)
    o = sink_attention(q[:, None], k_all[:, None], v_all[:, None], sinks, None)
    return o.reshape(b, t, D_ATTN), k_all[:, -WINDOW:], v_all[:, -WINDOW:]


def layer(x, conv_hist, ffn_hist, attn_fn, g_attn_norm, w_in, conv_w, conv_b, conv_ln_g, conv_ln_b, sinks,
          g_out_conv, g_out_attn, w_out, g_ffn_norm, w_up, ffn_conv_w, ffn_conv_b, w_down):
    b, t = x.shape[0], x.shape[1]
    h = rmsnorm(x, g_attn_norm)
    u = h @ w_in
    ga, gb, q, k, v = jnp.split(u, [D_CONV, 2 * D_CONV, 2 * D_CONV + D_ATTN, 2 * D_CONV + D_ATTN + D_KV], axis=-1)
    glu = ga * jax.nn.sigmoid(gb)
    cy, conv_new = causal_dwconv(glu, conv_hist, conv_w, conv_b)
    cy = jax.nn.silu(layernorm(cy, conv_ln_g, conv_ln_b))
    q = q.reshape(b, t, N_KV_HEADS, GROUP, HEAD_DIM)
    k = k.reshape(b, t, N_KV_HEADS, HEAD_DIM)
    v = v.reshape(b, t, N_KV_HEADS, HEAD_DIM)
    ao, k_new, v_new = attn_fn(q, k, v, sinks)
    mix = jnp.concatenate([rmsnorm(cy, g_out_conv), rmsnorm(ao, g_out_attn)], axis=-1)
    x = x + mix @ w_out
    h2 = rmsnorm(x, g_ffn_norm)
    gate, val = jnp.split(h2 @ w_up, 2, axis=-1)
    gc, ffn_new = causal_dwconv(gate, ffn_hist, ffn_conv_w, ffn_conv_b)
    x = x + (jax.nn.gelu(gc) * val) @ w_down
    return x, conv_new, k_new, v_new, ffn_new


def setup_inputs(seed: int = 0) -> dict:
    key = jax.random.key(seed)
    ks = jax.random.split(key, 24)
    f32 = jnp.float32
    nrm = lambda k, shp, sc: jax.random.normal(k, shp, f32) * sc
    L = DEPTH
    return {
        'x_prompt': nrm(ks[0], (BATCH, SEQ, D_MODEL), 1.0),
        'x_sample': nrm(ks[1], (DEC_BATCH, DEC_SEQ, D_MODEL), 1.0),
        'cache_conv': nrm(ks[2], (L, DEC_BATCH, CONV_WIDTH - 1, D_CONV), 0.5),
        'cache_k': nrm(ks[3], (L, DEC_BATCH, WINDOW, N_KV_HEADS, HEAD_DIM), 1.0),
        'cache_v': nrm(ks[4], (L, DEC_BATCH, WINDOW, N_KV_HEADS, HEAD_DIM), 1.0),
        'cache_ffn_conv': nrm(ks[5], (L, DEC_BATCH, FFN_CONV_WIDTH - 1, D_FF), 1.0),
        'g_attn_norm': 1.0 + nrm(ks[6], (L, D_MODEL), 0.01),
        'w_in': nrm(ks[7], (L, D_MODEL, D_IN), D_MODEL ** -0.5),
        'conv_w': nrm(ks[8], (L, CONV_WIDTH, D_CONV), CONV_WIDTH ** -0.5),
        'conv_b': nrm(ks[9], (L, D_CONV), 0.01),
        'conv_ln_g': 1.0 + nrm(ks[10], (L, D_CONV), 0.01),
        'conv_ln_b': nrm(ks[11], (L, D_CONV), 0.01),
        'sinks': nrm(ks[12], (L, N_Q_HEADS), 0.5),
        'g_out_conv': 1.0 + nrm(ks[13], (L, D_CONV), 0.01),
        'g_out_attn': 1.0 + nrm(ks[14], (L, D_ATTN), 0.01),
        'w_out': nrm(ks[15], (L, D_MIX, D_MODEL), D_MIX ** -0.5),
        'g_ffn_norm': 1.0 + nrm(ks[16], (L, D_MODEL), 0.01),
        'w_up': nrm(ks[17], (L, D_MODEL, 2 * D_FF), D_MODEL ** -0.5),
        'ffn_conv_w': nrm(ks[18], (L, FFN_CONV_WIDTH, D_FF), FFN_CONV_WIDTH ** -0.5),
        'ffn_conv_b': nrm(ks[19], (L, D_FF), 0.01),
        'w_down': nrm(ks[20], (L, D_FF, D_MODEL), D_FF ** -0.5),
        'g_final': 1.0 + nrm(ks[21], (D_MODEL,), 0.01),
    }


def reference(x_prompt, x_sample, cache_conv, cache_k, cache_v, cache_ffn_conv, g_attn_norm, w_in, conv_w,
              conv_b, conv_ln_g, conv_ln_b, sinks, g_out_conv, g_out_attn, w_out, g_ffn_norm, w_up,
              ffn_conv_w, ffn_conv_b, w_down, g_final):
    xp, xs = x_prompt, x_sample
    bp = xp.shape[0]
    pc, pk, pv, pf, sc, sk, sv, sf = [], [], [], [], [], [], [], []
    for l in range(DEPTH):
        w = (g_attn_norm[l], w_in[l], conv_w[l], conv_b[l], conv_ln_g[l], conv_ln_b[l], sinks[l],
             g_out_conv[l], g_out_attn[l], w_out[l], g_ffn_norm[l], w_up[l], ffn_conv_w[l], ffn_conv_b[l], w_down[l])
        xp, c_new, k_new, v_new, f_new = layer(
            xp, jnp.zeros((bp, CONV_WIDTH - 1, D_CONV), xp.dtype), jnp.zeros((bp, FFN_CONV_WIDTH - 1, D_FF), xp.dtype),
            attn_prompt, *w)
        pc.append(c_new); pk.append(k_new); pv.append(v_new); pf.append(f_new)
        xs, c_new, k_new, v_new, f_new = layer(
            xs, cache_conv[l], cache_ffn_conv[l],
            functools.partial(attn_sample, k_hist=cache_k[l], v_hist=cache_v[l]), *w)
        sc.append(c_new); sk.append(k_new); sv.append(v_new); sf.append(f_new)
    y_prompt = rmsnorm(xp, g_final)
    y_sample = rmsnorm(xs, g_final)
    return (y_prompt, y_sample, jnp.stack(pc), jnp.stack(pk), jnp.stack(pv), jnp.stack(pf),
            jnp.stack(sc), jnp.stack(sk), jnp.stack(sv), jnp.stack(sf))
```

```cpp
#include <hip/hip_runtime.h>
#include <cstdio>
#include <cstdint>

#ifndef MK_N_LAUNCHES
#define MK_N_LAUNCHES 7
#endif
constexpr int N_PHASES = 7;

constexpr int D = 1024, SEQ = 8192, NBP = 4, MP = NBP * SEQ, NBS = 32, TS = 32, MS = NBS * TS, M = MP + MS;
constexpr int DCONV = 512, DATT = 512, DKV = 128, DIN = 1792, DFF = 2816, NUP = 2 * DFF, CW = 31;
constexpr int QKVP = 768;
constexpr float EPS = 1e-6f;
constexpr float LOG2E = 1.4426950408889634f;
constexpr float C2 = 0.125f * LOG2E;
constexpr size_t O_Y = 0, O_CONV_P = (size_t)M * D, O_K_P = O_CONV_P + 4 * 30 * 512, O_V_P = O_K_P + 4 * 128 * 128, O_FFN_P = O_V_P + 4 * 128 * 128,
                 O_CONV_S = O_FFN_P + 4 * 2 * DFF, O_K_S = O_CONV_S + 32 * 30 * 512, O_V_S = O_K_S + 32 * 128 * 128, O_FFN_S = O_V_S + 32 * 128 * 128, O_END = O_FFN_S + 32 * 2 * DFF;
constexpr size_t MiB = 1u << 20;
constexpr size_t WS_CTL = 0, CTL_ZERO_BYTES = 1 * MiB;
constexpr size_t WS_WIN = 2 * MiB, WS_WOUT = 6 * MiB, WS_WUP = 8 * MiB, WS_WDN = 20 * MiB;
constexpr size_t WS_SS1 = 26 * MiB, WS_TAIL = 29 * MiB, WS_HEADG = 32 * MiB, WS_HEADV = 35 * MiB;
constexpr size_t WS_XN = 40 * MiB, WS_GLU = 106 * MiB, WS_QKV = 139 * MiB, WS_MIX = 190 * MiB, WS_X1B = 256 * MiB, WS_HID = 324 * MiB, WS_END = 506 * MiB;
static_assert(WS_WIN + (size_t)DIN * D * 2 <= WS_WOUT && WS_WOUT + (size_t)D * D * 2 <= WS_WUP && WS_WUP + (size_t)NUP * D * 2 <= WS_WDN && WS_WDN + (size_t)D * DFF * 2 <= WS_SS1, "ws map 1");
static_assert(WS_SS1 + (size_t)M * 64 <= WS_TAIL && WS_TAIL + (size_t)132 * 2 * DFF * 4 <= WS_HEADG && WS_HEADG + (size_t)132 * 2 * DFF * 4 <= WS_HEADV && WS_HEADV + (size_t)132 * 2 * DFF * 4 <= WS_XN, "ws map 2");
static_assert(WS_XN + (size_t)M * D * 2 <= WS_GLU && WS_GLU + (size_t)M * 512 * 2 <= WS_QKV && WS_QKV + (size_t)M * QKVP * 2 <= WS_MIX && WS_MIX + (size_t)M * D * 2 <= WS_X1B && WS_X1B + (size_t)M * D * 2 <= WS_HID && WS_HID + (size_t)M * DFF * 2 <= WS_END, "ws map 3");
constexpr int CW_TMO = 0, CW_CODE = 1, CW_BAR = 4096;
constexpr int RING_OFF = 0, RING_BYTES = 131072, EXT_OFF = RING_BYTES;
constexpr int MISC_OFF = EXT_OFF + 320, XB_OFF = EXT_OFF + 1024, ATT_WSF_OFF = EXT_OFF + 8192, ATT_RSS_OFF = EXT_OFF + 10240, ATT_RSTD_OFF = EXT_OFF + 12288;
constexpr int LDS_BYTES = 147456;

#define GAS __attribute__((address_space(1)))
#define LAS __attribute__((address_space(3)))
typedef unsigned short bf16;
typedef unsigned v4u __attribute__((ext_vector_type(4)));
typedef GAS unsigned gu32;
#define RLX_AGENT __ATOMIC_RELAXED, __HIP_MEMORY_SCOPE_AGENT
#define LDS_WAIT() asm volatile("s_waitcnt lgkmcnt(0)" ::: "memory")
#define VM_WAIT() asm volatile("s_waitcnt vmcnt(0)" ::: "memory")
__device__ __forceinline__ unsigned f2bf(float f) { unsigned u = __builtin_bit_cast(unsigned, f); return (u + 0x7fffu + ((u >> 16) & 1u)) >> 16; }
__device__ __forceinline__ unsigned pk2(float lo, float hi) { return f2bf(lo) | (f2bf(hi) << 16); }
__device__ __forceinline__ float bf2f(unsigned h) { return __builtin_bit_cast(float, h << 16); }
__device__ __forceinline__ float fast_sigmoid(float x) { return __builtin_amdgcn_rcpf(1.0f + __builtin_amdgcn_exp2f(-LOG2E * x)); }
template <int CTRL> __device__ __forceinline__ float dppf(float v) { return __builtin_bit_cast(float, __builtin_amdgcn_update_dpp(0, __builtin_bit_cast(int, v), CTRL, 0xf, 0xf, false)); }
__device__ __forceinline__ float row16_sum(float v) { v += dppf<0x128>(v); v += dppf<0x124>(v); v += dppf<0x122>(v); v += dppf<0x121>(v); return v; }
__device__ __forceinline__ float wave_sum(float v) { v = row16_sum(v); v += __shfl_xor(v, 16); v += __shfl_xor(v, 32); return v; }

namespace pg8 {
#define PG8_LAS __attribute__((address_space(3)))
typedef unsigned short bf16_t;
typedef short bf16x8 __attribute__((ext_vector_type(8)));
typedef float f32x4 __attribute__((ext_vector_type(4)));
typedef unsigned u32x4 __attribute__((ext_vector_type(4)));
constexpr int DFF_ = 2816;
constexpr int BM = 256, BK = 64, HALF = 128, HTB = HALF * BK * 2  , STAGE_BYTES = 8 * HTB, NXCD = 8, WGM = 8;

__host__ __device__ __forceinline__ int lds_byte(int r, int c) { const int st = (r >> 4) * 2 + (c >> 5), rr = r & 15, cc = c & 31, ob = rr * 64 + cc * 2; return st * 1024 + (ob ^ (((ob >> 9) & 1) << 5)); }
__host__ __device__ __forceinline__ void stage_rc(int b, int& R, int& C) { const int st = b / 1024, sb = b % 1024, swz = sb ^ (((sb >> 9) & 1) << 5); R = (st >> 1) * 16 + swz / 64; C = (st & 1) * 32 + (swz % 64) / 2; }
__host__ __device__ __forceinline__ int perm32(int rho) { const int n = rho >> 4, i = rho & 15; return 8 * (i >> 2) + 4 * n + (i & 3); }

struct Unit { int pm, pn; };
struct Gemm { const bf16_t* A; const bf16_t* Bt; int M, N, K; };

struct StaticOrder {
    int nM, nN, nwg, G, c;
    __host__ __device__ void init(int M, int N, int G_, int c_) { nM = M / BM; nN = N / BM; nwg = nM * nN; G = G_; c = c_; }
    __host__ __device__ bool next(int i, Unit& u) const {
        const long L = (long)i * G + c; if (L >= nwg) return false;
        int wgid = (int)L; { const int q = nwg / NXCD, r = nwg % NXCD, xcd = wgid % NXCD, off = wgid / NXCD; wgid = (xcd < r ? xcd * (q + 1) : r * (q + 1) + (xcd - r) * q) + off; }
        const int nig = WGM * nN, gid = wgid / nig, fm = gid * WGM, gsz = (nM - fm) < WGM ? (nM - fm) : WGM;
        u.pm = fm + ((wgid % nig) % gsz); u.pn = (wgid % nig) / gsz; return true;
    }
    __device__ __forceinline__ void a_ready(const Unit&) const {}
    __device__ __forceinline__ void done(const Unit&) const {}
};


__device__ __forceinline__ unsigned cvt_pk_bf16(float lo, float hi) { unsigned r; asm volatile("v_cvt_pk_bf16_f32 %0, %1, %2" : "=v"(r) : "v"(lo), "v"(hi)); return r; }
__device__ __forceinline__ u32x4 pack8(const f32x4 v0, const f32x4 v1) { u32x4 w; w.x = cvt_pk_bf16(v0[0], v0[1]); w.y = cvt_pk_bf16(v0[2], v0[3]); w.z = cvt_pk_bf16(v1[0], v1[1]); w.w = cvt_pk_bf16(v1[2], v1[3]); return w; }
__device__ __forceinline__ float sigm(float x) { return __builtin_amdgcn_rcpf(1.0f + __builtin_amdgcn_exp2f(-1.4426950408889634f * x)); }
__device__ __forceinline__ float gelu_tanh(float x) { const float inner = x * (1.0f + 0.044715f * x * x); return x * __builtin_amdgcn_rcpf(1.0f + __builtin_amdgcn_exp2f(-2.302208198f * inner)); }

struct EpiIn {
    static constexpr bool PERM = true, AFTER_DRAIN = false;
    bf16_t* GLU; bf16_t* QKV; float qscale;
    __device__ __forceinline__ void operator()(f32x4 (&acc)[2][2][4][2], const Unit& u, int wr, int wc, int fr, int fq, int wid, int lane) const {
        const int row0 = u.pm * BM + wr * 64 + fr;
        if (u.pn < 4) {
            const int col = u.pn * 128 + wc * 32 + 8 * fq;
#pragma unroll
            for (int ai = 0; ai < 2; ++ai)
#pragma unroll
                for (int m = 0; m < 4; ++m) {
                    f32x4 g0, g1;
#pragma unroll
                    for (int j = 0; j < 4; ++j) { g0[j] = acc[ai][0][m][0][j] * sigm(acc[ai][1][m][0][j]); g1[j] = acc[ai][0][m][1][j] * sigm(acc[ai][1][m][1][j]); }
                    *(u32x4*)(GLU + (size_t)(row0 + ai * HALF + m * 16) * 512 + col) = pack8(g0, g1);
                }
        } else {
            const float sc = u.pn < 6 ? qscale : 1.0f; const int colt = (u.pn - 4) * 256 + wc * 32 + 8 * fq;
#pragma unroll
            for (int ai = 0; ai < 2; ++ai)
#pragma unroll
                for (int m = 0; m < 4; ++m) { bf16_t* rowp = QKV + (size_t)(row0 + ai * HALF + m * 16) * 768 + colt;
#pragma unroll
                    for (int bj = 0; bj < 2; ++bj) *(u32x4*)(rowp + bj * HALF) = pack8(acc[ai][bj][m][0] * sc, acc[ai][bj][m][1] * sc); }
        }
    }
};

struct EpiOut {
    static constexpr bool PERM = true, AFTER_DRAIN = false;
    const float* xp; const float* xs; float* X1; bf16_t* X1B; float* SS1;
    __device__ __forceinline__ void operator()(f32x4 (&acc)[2][2][4][2], const Unit& u, int wr, int wc, int fr, int fq, int wid, int lane) const {
        const float* xbase = u.pm < 128 ? xp + (size_t)u.pm * BM * 1024 : xs + (size_t)(u.pm - 128) * BM * 1024;
        const int col0 = u.pn * BM + wc * 32 + 8 * fq;
#pragma unroll
        for (int ai = 0; ai < 2; ++ai)
#pragma unroll
            for (int m = 0; m < 4; ++m) {
                const int rt = ai * HALF + wr * 64 + m * 16 + fr; const size_t gr = (size_t)u.pm * BM + rt; float ss = 0.f;
#pragma unroll
                for (int bj = 0; bj < 2; ++bj) {
                    const f32x4 r0 = *(const f32x4*)(xbase + (size_t)rt * 1024 + col0 + bj * HALF), r1 = *(const f32x4*)(xbase + (size_t)rt * 1024 + col0 + bj * HALF + 4);
                    const f32x4 v0 = r0 + acc[ai][bj][m][0], v1 = r1 + acc[ai][bj][m][1];
                    *(f32x4*)(X1 + gr * 1024 + col0 + bj * HALF) = v0; *(f32x4*)(X1 + gr * 1024 + col0 + bj * HALF + 4) = v1;
                    *(u32x4*)(X1B + gr * 1024 + col0 + bj * HALF) = pack8(v0, v1);
                    ss += (v0[0] * v0[0] + v0[1] * v0[1]) + (v0[2] * v0[2] + v0[3] * v0[3]) + (v1[0] * v1[0] + v1[1] * v1[1]) + (v1[2] * v1[2] + v1[3] * v1[3]);
                }
                ss += __shfl_xor(ss, 16); ss += __shfl_xor(ss, 32);
                if (fq == 0) SS1[gr * 16 + u.pn * 4 + wc] = ss;
            }
    }
};

struct EpiDown {
    static constexpr bool PERM = true, AFTER_DRAIN = false;
    float* X;
    __device__ __forceinline__ void operator()(f32x4 (&acc)[2][2][4][2], const Unit& u, int wr, int wc, int fr, int fq, int wid, int lane) const {
        const int col0 = u.pn * BM + wc * 32 + 8 * fq;
#pragma unroll
        for (int ai = 0; ai < 2; ++ai)
#pragma unroll
            for (int m = 0; m < 4; ++m) {
                float* rowp = X + ((size_t)u.pm * BM + ai * HALF + wr * 64 + m * 16 + fr) * 1024 + col0;
#pragma unroll
                for (int bj = 0; bj < 2; ++bj) {
                    const f32x4 r0 = *(const f32x4*)(rowp + bj * HALF), r1 = *(const f32x4*)(rowp + bj * HALF + 4);
                    *(f32x4*)(rowp + bj * HALF) = r0 + acc[ai][bj][m][0]; *(f32x4*)(rowp + bj * HALF + 4) = r1 + acc[ai][bj][m][1];
                }
            }
    }
};

struct EpiUp {
    static constexpr bool PERM = true, AFTER_DRAIN = false;
    bf16_t* HID; const float* SS1; const float* cw; const float* cb; const float* cache; float* TAIL; float* HEADG; float* HEADV; float* out_ffn_s; PG8_LAS float* XB;
    __device__ __forceinline__ void operator()(f32x4 (&acc)[2][2][4][2], const Unit& u, int wr, int wc, int fr, int fq, int wid, int lane) const {
        const int chl = wc * 32 + 8 * fq, chb = u.pn * 128 + chl;
#pragma unroll
        for (int ai = 0; ai < 2; ++ai)
#pragma unroll
            for (int m = 0; m < 4; ++m) {
                const size_t gr = (size_t)u.pm * BM + ai * HALF + wr * 64 + m * 16 + fr;
                const f32x4 s0 = *(const f32x4*)(SS1 + gr * 16), s1 = *(const f32x4*)(SS1 + gr * 16 + 4), s2 = *(const f32x4*)(SS1 + gr * 16 + 8), s3 = *(const f32x4*)(SS1 + gr * 16 + 12);
                const float ss = ((s0[0] + s0[1]) + (s0[2] + s0[3])) + ((s1[0] + s1[1]) + (s1[2] + s1[3])) + ((s2[0] + s2[1]) + (s2[2] + s2[3])) + ((s3[0] + s3[1]) + (s3[2] + s3[3]));
                const float rs = __builtin_amdgcn_rsqf(ss * (1.0f / 1024.0f) + 1e-6f);
#pragma unroll
                for (int bj = 0; bj < 2; ++bj)
#pragma unroll
                    for (int n = 0; n < 2; ++n) acc[ai][bj][m][n] = acc[ai][bj][m][n] * rs;
            }
        asm volatile("" ::: "memory");
        f32x4 w0[2], w1[2], w2[2], bb[2];
#pragma unroll
        for (int n = 0; n < 2; ++n) { w0[n] = *(const f32x4*)(cw + chb + 4 * n); w1[n] = *(const f32x4*)(cw + DFF_ + chb + 4 * n); w2[n] = *(const f32x4*)(cw + 2 * DFF_ + chb + 4 * n); bb[n] = *(const f32x4*)(cb + chb + 4 * n); }
        const bool prompt = u.pm < 128;
        const bool sel15 = (fr == 15), sel14 = (fr >= 14);
        if (prompt) {
#pragma unroll
            for (int ai = 0; ai < 2; ++ai) {
                const int bnext = 2 * ai + wr + 1;
                if (fr >= 14) {
                    if (bnext < 4) {
#pragma unroll
                        for (int n = 0; n < 2; ++n) *(PG8_LAS f32x4*)(XB + (bnext * 2 + (fr - 14)) * 128 + chl + 4 * n) = acc[ai][0][3][n];
                    } else {
#pragma unroll
                        for (int n = 0; n < 2; ++n) *(f32x4*)(TAIL + ((size_t)u.pm * 2 + (fr - 14)) * DFF_ + chb + 4 * n) = acc[ai][0][3][n];
                    }
                }
            }
            const bool head_unknown = (u.pm & 31) != 0;
            if (head_unknown && wr == 0 && fr < 2) {
#pragma unroll
                for (int n = 0; n < 2; ++n) { *(f32x4*)(HEADG + ((size_t)u.pm * 2 + fr) * DFF_ + chb + 4 * n) = acc[0][0][0][n]; *(f32x4*)(HEADV + ((size_t)u.pm * 2 + fr) * DFF_ + chb + 4 * n) = acc[0][1][0][n]; }
            }
            asm volatile("s_waitcnt lgkmcnt(0)" ::: "memory"); __builtin_amdgcn_s_barrier(); asm volatile("" ::: "memory");
#pragma unroll
            for (int ai = 0; ai < 2; ++ai) {
                const int bnd = 2 * ai + wr;
                f32x4 pv[2];
                if (bnd == 0) { pv[0] = (f32x4){0.f, 0.f, 0.f, 0.f}; pv[1] = pv[0]; }
                else {
#pragma unroll
                    for (int n = 0; n < 2; ++n) pv[n] = *(const PG8_LAS f32x4*)(XB + (bnd * 2 + (fr & 1)) * 128 + chl + 4 * n);
                }
#pragma unroll
                for (int m = 0; m < 4; ++m) {
                    f32x4 h[2];
#pragma unroll
                    for (int n = 0; n < 2; ++n)
#pragma unroll
                        for (int j = 0; j < 4; ++j) {
                            const float g = acc[ai][0][m][n][j], p = pv[n][j];
                            const float t1 = dppf<0x121>(sel15 ? p : g), t2 = dppf<0x122>(sel14 ? p : g);
                            const float gc = w2[n][j] * g + (w1[n][j] * t1 + (w0[n][j] * t2 + bb[n][j]));
                            h[n][j] = gelu_tanh(gc) * acc[ai][1][m][n][j];
                        }
                    pv[0] = acc[ai][0][m][0]; pv[1] = acc[ai][0][m][1];
                    const bool skip = head_unknown && bnd == 0 && m == 0 && fr < 2;
                    if (!skip) *(u32x4*)(HID + ((size_t)u.pm * BM + ai * HALF + wr * 64 + m * 16 + fr) * DFF_ + chb) = pack8(h[0], h[1]);
                }
            }
        } else {
#pragma unroll
            for (int ai = 0; ai < 2; ++ai) {
                f32x4 pv[2];
#pragma unroll
                for (int m = 0; m < 4; ++m) {
                    const int b = 8 * (u.pm - 128) + 4 * ai + 2 * wr + (m >> 1);
                    if ((m & 1) == 0) {
#pragma unroll
                        for (int n = 0; n < 2; ++n) pv[n] = *(const f32x4*)(cache + ((size_t)b * 2 + (fr & 1)) * DFF_ + chb + 4 * n);
                    } else if (fr >= 14) {
#pragma unroll
                        for (int n = 0; n < 2; ++n) *(f32x4*)(out_ffn_s + ((size_t)b * 2 + (fr - 14)) * DFF_ + chb + 4 * n) = acc[ai][0][m][n];
                    }
                    f32x4 h[2];
#pragma unroll
                    for (int n = 0; n < 2; ++n)
#pragma unroll
                        for (int j = 0; j < 4; ++j) {
                            const float g = acc[ai][0][m][n][j], p = pv[n][j];
                            const float t1 = dppf<0x121>(sel15 ? p : g), t2 = dppf<0x122>(sel14 ? p : g);
                            const float gc = w2[n][j] * g + (w1[n][j] * t1 + (w0[n][j] * t2 + bb[n][j]));
                            h[n][j] = gelu_tanh(gc) * acc[ai][1][m][n][j];
                        }
                    pv[0] = acc[ai][0][m][0]; pv[1] = acc[ai][0][m][1];
                    *(u32x4*)(HID + ((size_t)u.pm * BM + ai * HALF + wr * 64 + m * 16 + fr) * DFF_ + chb) = pack8(h[0], h[1]);
                }
            }
        }
    }
};
template <class Epi, class Sched, bool ALIGN_EPI = false, bool SP2 = false>
__device__ __forceinline__ void gemm_phase(PG8_LAS unsigned char* lds, const Gemm g, const Sched& S, const Epi& E) {
    const int tid = threadIdx.x, wid = __builtin_amdgcn_readfirstlane(tid >> 6), lane = tid & 63, wr = wid >> 2, wc = wid & 3, fr = lane & 15, fq = lane >> 4;
    const int K = g.K, nt = K / BK;
    unsigned voffA[2], voffB[2];
#pragma unroll
    for (int i = 0; i < 2; ++i) { int R, C; stage_rc(tid * 16 + i * 8192, R, C); const int Rb = Epi::PERM ? ((R & ~31) + perm32(R & 31)) : R;
        voffA[i] = (unsigned)(R * K + C) * 2u; voffB[i] = (unsigned)(Rb * K + C) * 2u; }
    const size_t kstep = (size_t)(BK * 2);
    const size_t hstep = (size_t)HALF * K * 2;
    const size_t tstep = 2 * hstep;
    const unsigned ldsw = (unsigned)wid * 1024u;
    const int aoff = lds_byte(wr * 64 + fr, fq * 8), boff = lds_byte(wc * 32 + fr, fq * 8);
#define PG8_SA(b, h) (((b) * 2 + (h)) * HTB)
#define PG8_SB(b, h) ((4 + (b) * 2 + (h)) * HTB)
#define PG8_STAGE(bufoff, gbase, voff) do { _Pragma("unroll") for (int _i = 0; _i < 2; ++_i) \
        __builtin_amdgcn_global_load_lds((const unsigned*)((const char*)(gbase) + (voff)[_i]), (PG8_LAS unsigned*)(lds + (bufoff) + ldsw + _i * 8192), 16, 0, 0); } while (0)
#define PG8_LDA(dst, b, h) do { _Pragma("unroll") for (int m = 0; m < 4; ++m) _Pragma("unroll") for (int k = 0; k < 2; ++k) dst[m][k] = *(const PG8_LAS bf16x8*)(lds + PG8_SA(b, h) + aoff + m * 2048 + k * 1024); } while (0)
#define PG8_LDB(dst, b, h) do { _Pragma("unroll") for (int n = 0; n < 2; ++n) _Pragma("unroll") for (int k = 0; k < 2; ++k) dst[n][k] = *(const PG8_LAS bf16x8*)(lds + PG8_SB(b, h) + boff + n * 2048 + k * 1024); } while (0)
#define PG8_MMA(ai, bj, At, Bt) do { __builtin_amdgcn_s_setprio(1); _Pragma("unroll") for (int m = 0; m < 4; ++m) _Pragma("unroll") for (int n = 0; n < 2; ++n) _Pragma("unroll") for (int k = 0; k < 2; ++k) \
        acc[ai][bj][m][n] = __builtin_amdgcn_mfma_f32_16x16x32_bf16(Bt[n][k], At[m][k], acc[ai][bj][m][n], 0, 0, 0); __builtin_amdgcn_s_setprio(0); } while (0)
#define PG8_WAIT_V(n) asm volatile("s_waitcnt vmcnt(" #n ")" ::: "memory")
#define PG8_WAIT_L(n) asm volatile("s_waitcnt lgkmcnt(" #n ")" ::: "memory")
#define PG8_BAR __builtin_amdgcn_s_barrier()
#define PG8_SCHED __builtin_amdgcn_sched_barrier(0)
    Unit cur, nxt; int ui = 0;
    if (!S.next(0, cur)) return;
    f32x4 acc[2][2][4][2];
#pragma unroll
    for (int a = 0; a < 2; ++a)
#pragma unroll
        for (int b = 0; b < 2; ++b)
#pragma unroll
            for (int m = 0; m < 4; ++m)
#pragma unroll
                for (int n = 0; n < 2; ++n) acc[a][b][m][n] = (f32x4){0.f, 0.f, 0.f, 0.f};
    bf16x8 At[4][2], B0[2][2], B1[2][2];
    const char* cA = (const char*)g.A + (size_t)cur.pm * tstep; const char* cB = (const char*)g.Bt + (size_t)cur.pn * tstep;
    S.a_ready(cur);
    if constexpr (SP2) {
        PG8_STAGE(PG8_SB(0, 0), cB, voffB); PG8_STAGE(PG8_SB(0, 1), cB + hstep, voffB); PG8_STAGE(PG8_SA(0, 0), cA, voffA); PG8_STAGE(PG8_SA(0, 1), cA + hstep, voffA);
        if (wr == 1) PG8_BAR;
        PG8_WAIT_V(2); PG8_BAR;
        PG8_STAGE(PG8_SB(1, 0), cB + kstep, voffB); PG8_STAGE(PG8_SA(1, 0), cA + kstep, voffA); PG8_STAGE(PG8_SB(1, 1), cB + hstep + kstep, voffB);
        PG8_WAIT_V(6); PG8_BAR;
    } else {
        PG8_STAGE(PG8_SB(0, 0), cB, voffB); PG8_STAGE(PG8_SA(0, 0), cA, voffA); PG8_STAGE(PG8_SB(0, 1), cB + hstep, voffB); PG8_STAGE(PG8_SA(0, 1), cA + hstep, voffA);
        if (wr == 1) PG8_BAR;
        PG8_WAIT_V(4); PG8_BAR;
        PG8_STAGE(PG8_SB(1, 0), cB + kstep, voffB); PG8_STAGE(PG8_SA(1, 0), cA + kstep, voffA); PG8_STAGE(PG8_SB(1, 1), cB + hstep + kstep, voffB);
        PG8_WAIT_V(6); PG8_BAR;
    }
    for (;;) {
        const bool has_next = S.next(ui + 1, nxt);
        const char* nA = has_next ? (const char*)g.A + (size_t)nxt.pm * tstep : cA; const char* nB = has_next ? (const char*)g.Bt + (size_t)nxt.pn * tstep : cB;
        for (int t = 0; t < nt; t += 2) {
            const bool last = (t == nt - 2);
            const char* a1 = cA + (size_t)(t + 1) * kstep;
            const char* a2 = last ? nA : cA + (size_t)(t + 2) * kstep; const char* b2 = last ? nB : cB + (size_t)(t + 2) * kstep;
            const char* a3 = a2 + kstep; const char* b3 = b2 + kstep;
            if (last && has_next) S.a_ready(nxt);
            if constexpr (SP2) {
            PG8_LDB(B0, 0, 0); PG8_LDB(B1, 0, 1); PG8_SCHED; PG8_LDA(At, 0, 0); PG8_STAGE(PG8_SA(1, 1), a1 + hstep, voffA);
            PG8_WAIT_V(8); PG8_WAIT_L(0); PG8_BAR; PG8_MMA(0, 0, At, B0); PG8_MMA(0, 1, At, B1); PG8_BAR; PG8_SCHED;
            PG8_LDA(At, 0, 1); PG8_STAGE(PG8_SB(0, 0), b2, voffB); PG8_STAGE(PG8_SB(0, 1), b2 + hstep, voffB); PG8_STAGE(PG8_SA(0, 0), a2, voffA);
            PG8_WAIT_V(8); PG8_WAIT_L(0); PG8_BAR; PG8_MMA(1, 0, At, B0); PG8_MMA(1, 1, At, B1); PG8_BAR; PG8_SCHED;
            PG8_LDB(B0, 1, 0); PG8_LDB(B1, 1, 1); PG8_SCHED; PG8_LDA(At, 1, 0); PG8_STAGE(PG8_SA(0, 1), a2 + hstep, voffA);
            PG8_WAIT_V(8); PG8_WAIT_L(0); PG8_BAR; PG8_MMA(0, 0, At, B0); PG8_MMA(0, 1, At, B1); PG8_BAR; PG8_SCHED;
            PG8_LDA(At, 1, 1); PG8_STAGE(PG8_SB(1, 0), b3, voffB); PG8_STAGE(PG8_SB(1, 1), b3 + hstep, voffB); PG8_STAGE(PG8_SA(1, 0), a3, voffA);
            PG8_WAIT_V(8); PG8_WAIT_L(0); PG8_BAR; PG8_MMA(1, 0, At, B0); PG8_MMA(1, 1, At, B1); PG8_BAR; PG8_SCHED;
            } else {
            PG8_LDB(B0, 0, 0); PG8_SCHED; PG8_LDA(At, 0, 0); PG8_STAGE(PG8_SA(1, 1), a1 + hstep, voffA);
            PG8_WAIT_L(8); PG8_BAR; PG8_WAIT_L(0); PG8_MMA(0, 0, At, B0); PG8_BAR; PG8_SCHED;
            PG8_LDB(B1, 0, 1); PG8_STAGE(PG8_SB(0, 0), b2, voffB);
            PG8_BAR; PG8_WAIT_L(0); PG8_MMA(0, 1, At, B1); PG8_BAR;
            PG8_LDA(At, 0, 1); PG8_STAGE(PG8_SA(0, 0), a2, voffA);
            PG8_BAR; PG8_WAIT_L(0); PG8_MMA(1, 0, At, B0); PG8_BAR; PG8_SCHED;
            PG8_STAGE(PG8_SB(0, 1), b2 + hstep, voffB);
            PG8_WAIT_V(6); PG8_BAR; PG8_MMA(1, 1, At, B1); PG8_BAR;
            PG8_LDB(B0, 1, 0); PG8_SCHED; PG8_LDA(At, 1, 0); PG8_STAGE(PG8_SA(0, 1), a2 + hstep, voffA);
            PG8_WAIT_L(8); PG8_BAR; PG8_WAIT_L(0); PG8_MMA(0, 0, At, B0); PG8_BAR; PG8_SCHED;
            PG8_LDB(B1, 1, 1); PG8_STAGE(PG8_SB(1, 0), b3, voffB);
            PG8_BAR; PG8_WAIT_L(0); PG8_MMA(0, 1, At, B1); PG8_BAR;
            PG8_LDA(At, 1, 1); PG8_STAGE(PG8_SA(1, 0), a3, voffA);
            PG8_BAR; PG8_WAIT_L(0); PG8_MMA(1, 0, At, B0); PG8_BAR; PG8_SCHED;
            PG8_STAGE(PG8_SB(1, 1), b3 + hstep, voffB);
            PG8_WAIT_V(6); PG8_BAR; PG8_MMA(1, 1, At, B1); PG8_BAR;
            }
        }
        if constexpr (ALIGN_EPI) { if (wr == 0) PG8_BAR; }
        if constexpr (!Epi::AFTER_DRAIN) { E(acc, cur, wr, wc, fr, fq, wid, lane); S.done(cur); }
        if (!has_next) break;
#pragma unroll
        for (int a = 0; a < 2; ++a)
#pragma unroll
            for (int b = 0; b < 2; ++b)
#pragma unroll
                for (int m = 0; m < 4; ++m)
#pragma unroll
                    for (int n = 0; n < 2; ++n) acc[a][b][m][n] = (f32x4){0.f, 0.f, 0.f, 0.f};
        cur = nxt; cA = nA; cB = nB; ++ui;
        if constexpr (ALIGN_EPI) { if (wr == 1) PG8_BAR; }
    }
    PG8_WAIT_V(0);
    if constexpr (!ALIGN_EPI) { if (wr == 0) PG8_BAR; }
    PG8_BAR;

#undef PG8_SA
#undef PG8_SB
#undef PG8_STAGE
#undef PG8_LDA
#undef PG8_LDB
#undef PG8_MMA
#undef PG8_WAIT_V
#undef PG8_WAIT_L
#undef PG8_BAR
#undef PG8_SCHED
}
}

namespace mix {
using bf16x8 = __attribute__((ext_vector_type(8))) short;
using s16x4 = __attribute__((ext_vector_type(4))) short;
using f32x16 = __attribute__((ext_vector_type(16))) float;
using f32x4 = __attribute__((ext_vector_type(4))) float;
using f32x2 = __attribute__((ext_vector_type(2))) float;
using u32x4 = __attribute__((ext_vector_type(4))) unsigned;
using u32x2 = __attribute__((ext_vector_type(2))) unsigned;
#define SBAR() __builtin_amdgcn_sched_barrier(0)
__device__ __forceinline__ int crow(int r, int hi) { return (r & 3) + 8 * (r >> 2) + 4 * hi; }
typedef float f32x2_t __attribute__((ext_vector_type(2))); typedef __bf16 bf16x2_t __attribute__((ext_vector_type(2)));
__device__ __forceinline__ unsigned cvtpk_s(float lo, float hi) { f32x2_t v = {lo, hi}; bf16x2_t b = __builtin_convertvector(v, bf16x2_t); return __builtin_bit_cast(unsigned, b); }

__device__ __forceinline__ void qkt(f32x16& p0, f32x16& p1, const char* Kslot, const bf16x8* qr, int r32, int hi) {
    const char* kb = Kslot + hi * 1024 + r32 * 16;
    const f32x16 z = f32x16{};
#pragma unroll
    for (int d0 = 0; d0 < 4; ++d0) {
        const bf16x8 b0 = *reinterpret_cast<const bf16x8*>(kb + d0 * 2048);
        const bf16x8 b1 = *reinterpret_cast<const bf16x8*>(kb + d0 * 2048 + 512);
        if (d0 == 0) { p0 = __builtin_amdgcn_mfma_f32_32x32x16_bf16(b0, qr[0], z, 0, 0, 0); p1 = __builtin_amdgcn_mfma_f32_32x32x16_bf16(b1, qr[0], z, 0, 0, 0); }
        else { p0 = __builtin_amdgcn_mfma_f32_32x32x16_bf16(b0, qr[d0], p0, 0, 0, 0); p1 = __builtin_amdgcn_mfma_f32_32x32x16_bf16(b1, qr[d0], p1, 0, 0, 0); }
    }
}
__device__ __forceinline__ void pv(f32x16* o, int vb, bf16x8 pa0, bf16x8 pa1, bf16x8 pa2, bf16x8 pa3) {
#pragma unroll
    for (int d0 = 0; d0 < 2; ++d0) { s16x4 lo[4], hi[4];
#pragma unroll
        for (int ks = 0; ks < 4; ++ks) {
            asm volatile("ds_read_b64_tr_b16 %0,%1 offset:%c2" : "=&v"(lo[ks]) : "v"(vb), "i"(d0 * 4096 + ks * 1024) : "memory");
            asm volatile("ds_read_b64_tr_b16 %0,%1 offset:%c2" : "=&v"(hi[ks]) : "v"(vb), "i"(d0 * 4096 + ks * 1024 + 512) : "memory"); }
        asm volatile("s_waitcnt lgkmcnt(0)" ::: "memory"); SBAR();
#define PK(k) (bf16x8){lo[k][0], lo[k][1], lo[k][2], lo[k][3], hi[k][0], hi[k][1], hi[k][2], hi[k][3]}
        o[d0] = __builtin_amdgcn_mfma_f32_32x32x16_bf16(pa0, PK(0), o[d0], 0, 0, 0);
        o[d0] = __builtin_amdgcn_mfma_f32_32x32x16_bf16(pa1, PK(1), o[d0], 0, 0, 0);
        o[d0] = __builtin_amdgcn_mfma_f32_32x32x16_bf16(pa2, PK(2), o[d0], 0, 0, 0);
        o[d0] = __builtin_amdgcn_mfma_f32_32x32x16_bf16(pa3, PK(3), o[d0], 0, 0, 0);
#undef PK
    }
}
__device__ __forceinline__ float lmax32(const f32x16& p0, const f32x16& p1) {
    float a = fmaxf(p0[0], p1[0]);
#pragma unroll
    for (int r = 1; r < 16; ++r) a = fmaxf(a, fmaxf(p0[r], p1[r]));
    return a;
}

constexpr int KV_TILE = 16384;
constexpr int ATT_OST = 98304;
template <bool SAMPLE>
__device__ __forceinline__ void attn_unit(char* shm, char* ext, int b, int c, const bf16* QKV, const float* cache_k, const float* cache_v, const float* sinks, const float* g_attn, bf16* MIX) {
    const int tid = threadIdx.x, lane = tid & 63, r32 = lane & 31, hi = lane >> 5; const int wid = __builtin_amdgcn_readfirstlane(tid >> 6);
    const int m0 = SAMPLE ? MP + TS * b : b * SEQ + 64 * c;
#pragma unroll
    for (int i = 0; i < 12; ++i) {
        const int th = i >> 1, j = th >> 1, h = th & 1; const bool isV = (i & 1) != 0; const int idx = tid;
        int r, dst; int col;
        if (!isV) { r = (idx & 7) | ((idx >> 6) << 3); const int ch = (idx >> 3) & 7; dst = ch * 1024 + r * 16; col = ch * 8; }
        else { const int cc = (idx & 3) | (((idx >> 6) & 1) << 2); r = ((idx >> 2) & 15) | ((idx >> 7) << 4); dst = 8192 + ((idx >> 6) & 1) * 4096 + (idx >> 7) * 1024 + (idx & 63) * 16; col = cc * 8; }
        u32x4 val = (u32x4){0u, 0u, 0u, 0u};
        if (!SAMPLE) {
            const int ck = c - 2 + j;
            if (ck >= 0) val = *(const u32x4*)(QKV + (size_t)(b * SEQ + 64 * ck + r) * QKVP + 512 + (isV ? 128 : 0) + h * 64 + col);
        } else {
            if (j < 2) { const float* src = (isV ? cache_v : cache_k) + ((size_t)(b * 128 + 64 * j + r) * 2 + h) * 64 + col;
                const f32x4 a = *(const f32x4*)src, bq = *(const f32x4*)(src + 4);
                val.x = cvtpk_s(a[0], a[1]); val.y = cvtpk_s(a[2], a[3]); val.z = cvtpk_s(bq[0], bq[1]); val.w = cvtpk_s(bq[2], bq[3]); }
            else if (r < 32) val = *(const u32x4*)(QKV + (size_t)(MP + TS * b + r) * QKVP + 512 + (isV ? 128 : 0) + h * 64 + col);
        }
        *(u32x4*)(shm + (j * 2 + h) * KV_TILE + dst) = val;
    }
    __syncthreads();
    const int head = wid, hk = head >> 2;
    const float sink2 = sinks[head] * LOG2E;
    const unsigned lds0 = (unsigned)(uintptr_t)shm;
    float* wsf = (float*)(ext + (ATT_WSF_OFF - EXT_OFF)) + wid * 64;
    float* rss = (float*)(ext + (ATT_RSS_OFF - EXT_OFF));
    float* rstd = (float*)(ext + (ATT_RSTD_OFF - EXT_OFF));
    constexpr int NH = SAMPLE ? 1 : 2;
    const float g0 = g_attn[head * 64 + r32], g1 = g_attn[head * 64 + 32 + r32];
    bf16* stg = (bf16*)(shm + ATT_OST) + wid * 2048;
#pragma unroll
    for (int half = 0; half < NH; ++half) {
        const bf16* Qw = QKV + (size_t)(m0 + half * 32 + r32) * QKVP + head * 64 + hi * 8;
        bf16x8 qr[4];
#pragma unroll
        for (int d0 = 0; d0 < 4; ++d0) qr[d0] = *reinterpret_cast<const bf16x8*>(Qw + d0 * 16);
        f32x16 P[3][2];
#pragma unroll
        for (int j = 0; j < 3; ++j) qkt(P[j][0], P[j][1], shm + (j * 2 + hk) * KV_TILE, qr, r32, hi);
        if (!SAMPLE) {
#pragma unroll
            for (int j = 0; j < 2; ++j) if (c - 2 + j < 0) {
#pragma unroll
                for (int r = 0; r < 16; ++r) { P[j][0][r] = -1e30f; P[j][1][r] = -1e30f; } }
        } else {
#pragma unroll
            for (int r = 0; r < 16; ++r) P[2][1][r] = -1e30f;
        }
        float mx = fmaxf(fmaxf(lmax32(P[0][0], P[0][1]), lmax32(P[1][0], P[1][1])), lmax32(P[2][0], P[2][1]));
        { auto rr = __builtin_amdgcn_permlane32_swap(__float_as_uint(mx), __float_as_uint(mx), false, false); mx = fmaxf(__uint_as_float(rr[0]), __uint_as_float(rr[1])); }
        mx = fmaxf(mx, sink2);
        float l = 0.f;
        u32x4 pw[3][4];
#pragma unroll
        for (int j = 0; j < 3; ++j) {
#pragma unroll
            for (int t = 0; t < 2; ++t)
#pragma unroll
                for (int r = 0; r < 16; ++r) { const float e = __builtin_amdgcn_exp2f(P[j][t][r] - mx); P[j][t][r] = e; l += e; }
#define PKW(X, B) cvtpk_s(X[B], X[B + 1])
            pw[j][0] = (u32x4){PKW(P[j][0], 0), PKW(P[j][0], 2), PKW(P[j][0], 4), PKW(P[j][0], 6)}; pw[j][1] = (u32x4){PKW(P[j][0], 8), PKW(P[j][0], 10), PKW(P[j][0], 12), PKW(P[j][0], 14)};
            pw[j][2] = (u32x4){PKW(P[j][1], 0), PKW(P[j][1], 2), PKW(P[j][1], 4), PKW(P[j][1], 6)}; pw[j][3] = (u32x4){PKW(P[j][1], 8), PKW(P[j][1], 10), PKW(P[j][1], 12), PKW(P[j][1], 14)};
#undef PKW
            asm volatile("" : "+v"(pw[j][0]), "+v"(pw[j][1]), "+v"(pw[j][2]), "+v"(pw[j][3]));
        }
        { auto rr = __builtin_amdgcn_permlane32_swap(__float_as_uint(l), __float_as_uint(l), false, false); l = __uint_as_float(rr[0]) + __uint_as_float(rr[1]); }
        l += __builtin_amdgcn_exp2f(sink2 - mx);
        f32x16 o[2]; o[0] = f32x16{}; o[1] = f32x16{};
#pragma unroll
        for (int j = 0; j < 3; ++j) {
            const int vb = (int)(lds0 + (j * 2 + hk) * KV_TILE + 8192) + ((lane >> 4) & 1) * 32 + (lane & 3) * 8 + (4 * hi + ((lane & 15) >> 2)) * 64;
            SBAR();
            pv(o, vb, __builtin_bit_cast(bf16x8, pw[j][0]), __builtin_bit_cast(bf16x8, pw[j][1]), __builtin_bit_cast(bf16x8, pw[j][2]), __builtin_bit_cast(bf16x8, pw[j][3]));
        }
        if (hi == 0) wsf[32 + r32] = l;
        asm volatile("s_waitcnt lgkmcnt(0)" ::: "memory");
#pragma unroll
        for (int r = 0; r < 16; ++r) { const float rl = __builtin_amdgcn_rcpf(wsf[32 + crow(r, hi)]); o[0][r] *= rl; o[1][r] *= rl; }
        asm volatile("s_waitcnt lgkmcnt(0)" ::: "memory");
#pragma unroll
        for (int r = 0; r < 16; ++r) { float s = o[0][r] * o[0][r] + o[1][r] * o[1][r]; s = row16_sum(s); s += __shfl_xor(s, 16); if (r32 == 0) rss[head * 64 + crow(r, hi)] = s; }
        __syncthreads();
        if (tid < 32) { float t = 0.f;
#pragma unroll
            for (int hd = 0; hd < 8; ++hd) t += rss[hd * 64 + tid];
            rstd[tid] = __builtin_amdgcn_rsqf(t * (1.0f / 512.0f) + EPS); }
        __syncthreads();
#pragma unroll
        for (int r = 0; r < 16; ++r) { const int orow = crow(r, hi); const float rs = rstd[orow];
            stg[orow * 64 + r32] = (bf16)f2bf(o[0][r] * rs * g0); stg[orow * 64 + 32 + r32] = (bf16)f2bf(o[1][r] * rs * g1); }
        asm volatile("s_waitcnt lgkmcnt(0)" ::: "memory");
#pragma unroll
        for (int i = 0; i < 4; ++i) { const int row = i * 8 + (lane >> 3), ch = lane & 7; const u32x4 v = *(const u32x4*)(stg + row * 64 + ch * 8);
            *(u32x4*)(MIX + (size_t)(m0 + half * 32 + row) * D + 512 + head * 64 + ch * 8) = v; }
        asm volatile("s_waitcnt lgkmcnt(0)" ::: "memory");
    }
    __syncthreads();
}

constexpr int CONV_IN = 0, CONV_CY = 65536;
template <bool SAMPLE>
__device__ __forceinline__ void conv_unit(char* shm, int b, int rb, const bf16* GLU, const float* cache_conv, const f32x2 (&w)[CW], const f32x2 bias, const float* ln_g, const float* ln_b, const float* g_out, bf16* MIX, float* out_conv) {
    const int tid = threadIdx.x, lane = tid & 63; const int wid = __builtin_amdgcn_readfirstlane(tid >> 6);
    const int t0 = SAMPLE ? 0 : 32 * rb;
    const size_t mrow0 = SAMPLE ? (size_t)MP + (size_t)TS * b : (size_t)b * SEQ + t0;
    for (int p = tid; p < 62 * 64; p += 512) {
        const int i = p >> 6, pc = p & 63; u32x4 val = (u32x4){0u, 0u, 0u, 0u};
        if (!SAMPLE) { const int t = t0 - 30 + i; if (t >= 0) val = *(const u32x4*)(GLU + ((size_t)b * SEQ + t) * 512 + pc * 8); }
        else {
            if (i < 30) { const float* src = cache_conv + ((size_t)b * 30 + i) * 512 + pc * 8; const f32x4 a = *(const f32x4*)src, bq = *(const f32x4*)(src + 4);
                val.x = cvtpk_s(a[0], a[1]); val.y = cvtpk_s(a[2], a[3]); val.z = cvtpk_s(bq[0], bq[1]); val.w = cvtpk_s(bq[2], bq[3]); }
            else val = *(const u32x4*)(GLU + (mrow0 + (i - 30)) * 512 + pc * 8);
        }
        *(u32x4*)(shm + CONV_IN + i * 1024 + pc * 16) = val;
    }
    __syncthreads();
    if (out_conv) { for (int p = tid; p < 30 * 128; p += 512) { const int i = p >> 7, q4 = p & 127; const u32x2 v = *(const u32x2*)(shm + CONV_IN + (32 + i) * 1024 + q4 * 8);
            f32x4 f; f[0] = bf2f(v.x & 0xffffu); f[1] = bf2f(v.x >> 16); f[2] = bf2f(v.y & 0xffffu); f[3] = bf2f(v.y >> 16); *(f32x4*)(out_conv + (size_t)i * 512 + q4 * 4) = f; } }
    { const int cp = tid & 255, rh = tid >> 8;
      f32x2 acc[16];
#pragma unroll
      for (int t = 0; t < 16; ++t) acc[t] = bias;
      const char* inb = shm + CONV_IN + (16 * rh) * 1024 + cp * 4;
#pragma unroll
      for (int i = 0; i < 46; ++i) {
          const unsigned xv = *(const unsigned*)(inb + i * 1024); const f32x2 x = (f32x2){bf2f(xv & 0xffffu), bf2f(xv >> 16)};
#pragma unroll
          for (int t = 0; t < 16; ++t) { if (i - t >= 0 && i - t <= 30) acc[t] = acc[t] + w[i - t] * x; }
      }
#pragma unroll
      for (int t = 0; t < 16; ++t) *(f32x2*)(shm + CONV_CY + (16 * rh + t) * 2048 + cp * 8) = acc[t];
    }
    __syncthreads();
    { f32x4 lg0 = *(const f32x4*)(ln_g + 8 * lane), lg1 = *(const f32x4*)(ln_g + 8 * lane + 4), lb0 = *(const f32x4*)(ln_b + 8 * lane), lb1 = *(const f32x4*)(ln_b + 8 * lane + 4);
      f32x4 go0 = *(const f32x4*)(g_out + 8 * lane), go1 = *(const f32x4*)(g_out + 8 * lane + 4);
#pragma unroll
      for (int rr = 0; rr < 4; ++rr) {
          const int row = 4 * wid + rr;
          f32x4 v0 = *(const f32x4*)(shm + CONV_CY + row * 2048 + lane * 32), v1 = *(const f32x4*)(shm + CONV_CY + row * 2048 + lane * 32 + 16);
          const float mean = wave_sum((v0[0] + v0[1]) + (v0[2] + v0[3]) + (v1[0] + v1[1]) + (v1[2] + v1[3])) * (1.0f / 512.0f);
          v0 = v0 - mean; v1 = v1 - mean;
          const float var = wave_sum((v0[0] * v0[0] + v0[1] * v0[1]) + (v0[2] * v0[2] + v0[3] * v0[3]) + (v1[0] * v1[0] + v1[1] * v1[1]) + (v1[2] * v1[2] + v1[3] * v1[3])) * (1.0f / 512.0f);
          const float rstd = __builtin_amdgcn_rsqf(var + EPS);
          v0 = v0 * rstd * lg0 + lb0; v1 = v1 * rstd * lg1 + lb1;
#pragma unroll
          for (int j = 0; j < 4; ++j) { v0[j] = v0[j] * fast_sigmoid(v0[j]); v1[j] = v1[j] * fast_sigmoid(v1[j]); }
          const float ms = wave_sum((v0[0] * v0[0] + v0[1] * v0[1]) + (v0[2] * v0[2] + v0[3] * v0[3]) + (v1[0] * v1[0] + v1[1] * v1[1]) + (v1[2] * v1[2] + v1[3] * v1[3])) * (1.0f / 512.0f);
          const float r2 = __builtin_amdgcn_rsqf(ms + EPS);
          v0 = v0 * r2 * go0; v1 = v1 * r2 * go1;
          u32x4 o; o.x = pk2(v0[0], v0[1]); o.y = pk2(v0[2], v0[3]); o.z = pk2(v1[0], v1[1]); o.w = pk2(v1[2], v1[3]);
          *(u32x4*)(MIX + (mrow0 + row) * D + 8 * lane) = o;
      }
    }
    __syncthreads();
}
#undef SBAR
}

template <int MODE> __device__ __forceinline__ int src_col(int n) {
    if (MODE == 1) return n < 1024 ? ((n >> 7) & 1) * 512 + (n >> 8) * 128 + (n & 127) : n;
    if (MODE == 2) return ((n >> 7) & 1) * DFF + (n >> 8) * 128 + (n & 127);
    return n;
}
template <int MODE> __device__ __forceinline__ void p0_transpose_item(const float* W, int K, int N, bf16* WT, LAS float* scr, int item, int lane, const float* kgain) {
    const int nblk = N / 32, kb = item / nblk, nb = item % nblk, k0 = 64 * kb, n0 = 32 * nb, s0 = src_col<MODE>(n0);
#pragma unroll 8
    for (int i = 0; i < 32; ++i) { const int kk = 2 * i + (lane >> 5); float v = W[(size_t)(k0 + kk) * N + s0 + (lane & 31)]; if (kgain) v *= kgain[k0 + kk]; scr[kk * 33 + (lane & 31)] = v; }
    LDS_WAIT(); asm volatile("" ::: "memory");
    const int c = lane & 7;
#pragma unroll
    for (int j = 0; j < 4; ++j) { const int n = (lane >> 3) + 8 * j; const LAS float* s = scr + (8 * c) * 33 + n;
        v4u o; o.x = pk2(s[0 * 33], s[1 * 33]); o.y = pk2(s[2 * 33], s[3 * 33]); o.z = pk2(s[4 * 33], s[5 * 33]); o.w = pk2(s[6 * 33], s[7 * 33]);
        *(GAS v4u*)(WT + (size_t)(n0 + n) * K + k0 + 8 * c) = o; }
    LDS_WAIT(); asm volatile("" ::: "memory");
}
typedef float f32x4 __attribute__((ext_vector_type(4)));
typedef float f32x2 __attribute__((ext_vector_type(2)));

#define XB_TMO      128
#define XB_XCNT(j)  (256  + 64 * (j))
#define XB_XSUB(j)  (1280 + 64 * (j))
#define XB_XGEN(j)  (2304 + 64 * (j))
#define XB_TOP      3328
#define XB_TOPGEN   3392
#define XCD_BAR_WORDS 3456
#define XB_SPIN_CAP (1u << 18)

__device__ __forceinline__ unsigned xb_ld(unsigned* p)              { return __hip_atomic_load(p, __ATOMIC_RELAXED, __HIP_MEMORY_SCOPE_AGENT); }
__device__ __forceinline__ unsigned xb_add(unsigned* p, unsigned v) { return __hip_atomic_fetch_add(p, v, __ATOMIC_RELAXED, __HIP_MEMORY_SCOPE_AGENT); }
__device__ __forceinline__ unsigned xb_xcc_id() { return (unsigned)__builtin_amdgcn_s_getreg((3 << 11) | 20) & 0xFu; }
#define XB_SPIN(cond, bar) do { unsigned _sp = 0; while (cond) { __builtin_amdgcn_s_sleep(1); \
    if ((++_sp & 255u) == 0u) { if (xb_ld(&(bar)[XB_TMO])) break; if (_sp > XB_SPIN_CAP) { atomicAdd(&(bar)[XB_TMO], 1u); break; } } } } while (0)

struct XcdBarrier {
    unsigned* bar; unsigned x;
    volatile LAS unsigned* st;
};

__device__ __forceinline__ XcdBarrier xcd_barrier_post(unsigned* bar, volatile LAS unsigned* st) {
    XcdBarrier b; b.bar = bar; b.x = xb_xcc_id(); b.st = st;
    if (threadIdx.x == 0) (void)xb_add(&bar[XB_XCNT(b.x)], 1u);
    return b;
}
__device__ __forceinline__ void xcd_barrier_complete(unsigned* bar, unsigned x, unsigned& nloc, unsigned& nx) {
    const unsigned G = gridDim.x * gridDim.y * gridDim.z;
    unsigned sum, cnt, mine, sp = 0u;
    for (;;) {
        sum = 0u; cnt = 0u; mine = 0u;
#pragma unroll
        for (unsigned j = 0; j < 16; ++j) { const unsigned c = xb_ld(&bar[XB_XCNT(j)]); sum += c; cnt += (c > 0u) ? 1u : 0u; mine = (j == x) ? c : mine; }
        if (sum == G) break;
        __builtin_amdgcn_s_sleep(1);
        if ((++sp & 255u) == 0u) { if (xb_ld(&bar[XB_TMO])) break; if (sp > XB_SPIN_CAP) { atomicAdd(&bar[XB_TMO], 1u); break; } }
    }
    nloc = mine > 0u ? mine : 1u; nx = cnt > 0u ? cnt : 1u;
}

__device__ __forceinline__ void xcd_barrier(const XcdBarrier& b) {
    asm volatile("s_waitcnt vmcnt(0)" ::: "memory");
    __syncthreads();
    if (threadIdx.x == 0) {
        unsigned* bar = b.bar;
        __builtin_amdgcn_s_waitcnt(0);
        unsigned nloc = b.st[0], nx = b.st[1];
        if (nloc == 0u) { xcd_barrier_complete(bar, b.x, nloc, nx); b.st[0] = nloc; b.st[1] = nx; }
        const unsigned old = xb_add(&bar[XB_XSUB(b.x)], 1u);
        const unsigned gen = old / nloc;
        if (old + 1u == (gen + 1u) * nloc) {
            __builtin_amdgcn_fence(__ATOMIC_RELEASE, "agent");
            asm volatile("s_waitcnt vmcnt(0)" ::: "memory");
            const unsigned og = xb_add(&bar[XB_TOP], 1u);
            const unsigned tg = og / nx;
            if (og + 1u == (tg + 1u) * nx) xb_add(&bar[XB_TOPGEN], 1u);
            else XB_SPIN(xb_ld(&bar[XB_TOPGEN]) == tg, bar);
            __builtin_amdgcn_fence(__ATOMIC_ACQUIRE, "agent");
            xb_add(&bar[XB_XGEN(b.x)], 1u);
            asm volatile("s_waitcnt vmcnt(0)" ::: "memory");
        } else {
            XB_SPIN(xb_ld(&bar[XB_XGEN(b.x)]) == gen, bar);
            __builtin_amdgcn_fence(__ATOMIC_ACQUIRE, "agent");
            asm volatile("s_waitcnt vmcnt(0)" ::: "memory");
        }
    }
    __syncthreads();
}

struct Args { const float* in[22]; float* out; unsigned char* ws; int ph_lo, ph_hi, li, pad; };
__global__ void __launch_bounds__(512, 2) fwd_kernel(Args args) {
    extern __shared__ __attribute__((aligned(16))) unsigned char lds[];
    LAS unsigned char* ldsl = (LAS unsigned char*)lds;
    volatile LAS unsigned* MISC = (volatile LAS unsigned*)(ldsl + MISC_OFF);
    const int tid = threadIdx.x, lane = tid & 63, wave = __builtin_amdgcn_readfirstlane(tid >> 6);
    const int G = gridDim.x, bx = blockIdx.x; const int vcu = (G % 8 == 0) ? (bx % 8) * (G / 8) + bx / 8 : bx;
    unsigned char* ws = args.ws; gu32* ctl = (gu32*)(ws + WS_CTL); float* out = args.out;
    bf16* WIN_T = (bf16*)(ws + WS_WIN); bf16* WOUT_T = (bf16*)(ws + WS_WOUT); bf16* WUP_T = (bf16*)(ws + WS_WUP); bf16* WDN_T = (bf16*)(ws + WS_WDN);
    bf16* XN = (bf16*)(ws + WS_XN); bf16* GLU = (bf16*)(ws + WS_GLU); bf16* QKV = (bf16*)(ws + WS_QKV); bf16* MIX = (bf16*)(ws + WS_MIX); bf16* X1B = (bf16*)(ws + WS_X1B); bf16* HID = (bf16*)(ws + WS_HID);
    float* SS1 = (float*)(ws + WS_SS1); float* TAIL = (float*)(ws + WS_TAIL); float* HEADG = (float*)(ws + WS_HEADG); float* HEADV = (float*)(ws + WS_HEADV);
    for (int u = tid; u < (LDS_BYTES - EXT_OFF) / 4; u += 512) ((LAS unsigned*)(ldsl + EXT_OFF))[u] = 0u;
    __syncthreads();
    constexpr bool PER_PHASE = (MK_N_LAUNCHES == N_PHASES);
    XcdBarrier bar; bar.bar = (unsigned*)(ctl + CW_BAR); bar.x = 0; bar.st = nullptr;
    if (!PER_PHASE) bar = xcd_barrier_post((unsigned*)(ctl + CW_BAR) + args.li * XCD_BAR_WORDS, MISC + 8);
#define GRID_BAR() do { if (!PER_PHASE) xcd_barrier(bar); } while (0)
    const int lo = args.ph_lo, hi = args.ph_hi;
#ifndef PH_MASK
#define PH_MASK 0x7f
#endif
#define IN(k) (((PH_MASK >> (k)) & 1) && lo <= (k) && (k) < hi)
#define BOTH(k) (IN(k) && IN((k) + 1))
    const int gw = vcu * 8 + wave, NGW = G * 8;

    if (IN(0)) {
        LAS float* scr = (LAS float*)(ldsl + RING_OFF + wave * 16384);
        constexpr int I_IN = (D / 64) * (DIN / 32), I_OUT = (D / 64) * (D / 32), I_UP = (D / 64) * (NUP / 32), I_DN = (DFF / 64) * (D / 32);
        for (int it = gw; it < I_IN + I_OUT + I_UP + I_DN; it += NGW) {
            int r = it;
            if (r < I_IN) { p0_transpose_item<1>(args.in[7], D, DIN, WIN_T, scr, r, lane, nullptr); continue; } r -= I_IN;
            if (r < I_OUT) { p0_transpose_item<0>(args.in[15], D, D, WOUT_T, scr, r, lane, nullptr); continue; } r -= I_OUT;
            if (r < I_UP) { p0_transpose_item<2>(args.in[17], D, NUP, WUP_T, scr, r, lane, args.in[16]); continue; } r -= I_UP;
            p0_transpose_item<0>(args.in[20], DFF, D, WDN_T, scr, r, lane, nullptr);
        }
        f32x4 gv[4];
#pragma unroll
        for (int j = 0; j < 4; ++j) gv[j] = *(const f32x4*)(args.in[6] + 4 * lane + 256 * j);
        for (int m = gw; m < M; m += NGW) {
            const float* xrow = m < MP ? args.in[0] + (size_t)m * D : args.in[1] + (size_t)(m - MP) * D;
            f32x4 v[4]; float s = 0.f;
#pragma unroll
            for (int j = 0; j < 4; ++j) { v[j] = *(const f32x4*)(xrow + 4 * lane + 256 * j); s += (v[j][0] * v[j][0] + v[j][1] * v[j][1]) + (v[j][2] * v[j][2] + v[j][3] * v[j][3]); }
            const float rstd = __builtin_amdgcn_rsqf(wave_sum(s) * (1.0f / D) + EPS);
#pragma unroll
            for (int j = 0; j < 4; ++j) { const f32x4 o = v[j] * rstd * gv[j];
                *(unsigned long long*)(XN + (size_t)m * D + 4 * lane + 256 * j) = (unsigned long long)pk2(o[0], o[1]) | ((unsigned long long)pk2(o[2], o[3]) << 32); }
        }
        if (BOTH(0)) GRID_BAR();
    }

    if (IN(1)) {
        pg8::Gemm g{XN, WIN_T, M, DIN, D}; pg8::StaticOrder S; S.init(M, DIN, G, bx);
        pg8::EpiIn E{GLU, QKV, C2};
        pg8::gemm_phase<pg8::EpiIn, pg8::StaticOrder, true, true>(ldsl + RING_OFF, g, S, E);
        if (BOTH(1)) GRID_BAR();
    }

    if (IN(2)) {
#ifndef NO_CONV
        {
            mix::f32x2 w[CW]; const int cp = tid & 255;
#pragma unroll
            for (int j = 0; j < CW; ++j) w[j] = *(const mix::f32x2*)(args.in[8] + j * 512 + 2 * cp);
            const mix::f32x2 bias = *(const mix::f32x2*)(args.in[9] + 2 * cp);
            for (int u = vcu; u < 1024 + NBS; u += G) {
                if (u < 1024) { const int b = u >> 8, rb = u & 255;
                    mix::conv_unit<false>((char*)lds, b, rb, GLU, args.in[2], w, bias, args.in[10], args.in[11], args.in[13], MIX, rb == 255 ? out + O_CONV_P + (size_t)b * 30 * 512 : nullptr); }
                else { const int b = u - 1024;
                    mix::conv_unit<true>((char*)lds, b, 0, GLU, args.in[2], w, bias, args.in[10], args.in[11], args.in[13], MIX, out + O_CONV_S + (size_t)b * 30 * 512); }
            }
        }
#endif
#ifndef NO_ATT
        for (int u = G - 1 - vcu; u < 512 + NBS; u += G) {
            if (u < 512) mix::attn_unit<false>((char*)lds, (char*)lds + EXT_OFF, u >> 7, u & 127, QKV, args.in[3], args.in[4], args.in[12], args.in[14], MIX);
            else mix::attn_unit<true>((char*)lds, (char*)lds + EXT_OFF, u - 512, 0, QKV, args.in[3], args.in[4], args.in[12], args.in[14], MIX);
        }
#endif
        const int gt = vcu * 512 + tid, NGT = G * 512;
        for (int idx = gt; idx < 2 * 4 * 128 * 32; idx += NGT) {
            const int kv = idx >> 14, b = (idx >> 12) & 3, r = (idx >> 5) & 127, q = idx & 31;
            const mix::u32x2 v = *(const mix::u32x2*)(QKV + (size_t)(b * SEQ + SEQ - 128 + r) * QKVP + 512 + kv * 128 + q * 4);
            f32x4 f; f[0] = bf2f(v.x & 0xffffu); f[1] = bf2f(v.x >> 16); f[2] = bf2f(v.y & 0xffffu); f[3] = bf2f(v.y >> 16);
            *(f32x4*)(out + (kv ? O_V_P : O_K_P) + (size_t)(b * 128 + r) * 128 + q * 4) = f;
        }
        for (int idx = gt; idx < 2 * 32 * 128 * 32; idx += NGT) {
            const int kv = idx >> 17, b = (idx >> 12) & 31, r = (idx >> 5) & 127, q = idx & 31; f32x4 f;
            if (r < 96) f = *(const f32x4*)((kv ? args.in[4] : args.in[3]) + (size_t)(b * 128 + 32 + r) * 128 + q * 4);
            else { const mix::u32x2 v = *(const mix::u32x2*)(QKV + (size_t)(MP + TS * b + (r - 96)) * QKVP + 512 + kv * 128 + q * 4);
                f[0] = bf2f(v.x & 0xffffu); f[1] = bf2f(v.x >> 16); f[2] = bf2f(v.y & 0xffffu); f[3] = bf2f(v.y >> 16); }
            *(f32x4*)(out + (kv ? O_V_S : O_K_S) + (size_t)(b * 128 + r) * 128 + q * 4) = f;
        }
        if (BOTH(2)) GRID_BAR();
    }

    if (IN(3)) {
        pg8::Gemm g{MIX, WOUT_T, M, D, D}; pg8::StaticOrder S; S.init(M, D, G, bx);
        pg8::EpiOut E{args.in[0], args.in[1], out, X1B, SS1};
        pg8::gemm_phase<pg8::EpiOut, pg8::StaticOrder, true, true>(ldsl + RING_OFF, g, S, E);
        if (BOTH(3)) GRID_BAR();
    }

    if (IN(4)) {
        pg8::Gemm g{X1B, WUP_T, M, NUP, D}; pg8::StaticOrder S; S.init(M, NUP, G, bx);
        pg8::EpiUp E{HID, SS1, args.in[18], args.in[19], args.in[5], TAIL, HEADG, HEADV, out + O_FFN_S, (LAS float*)(ldsl + XB_OFF)};
        pg8::gemm_phase<pg8::EpiUp, pg8::StaticOrder, true, true>(ldsl + RING_OFF, g, S, E);
        if (BOTH(4)) GRID_BAR();
    }

    if (IN(5)) {
        pg8::Gemm g{HID, WDN_T, M, D, DFF}; pg8::StaticOrder S; S.init(M, D, G, bx);
        { pg8::Unit u; const float* cw = args.in[18]; const float* cb = args.in[19];
          for (int i = 0; S.next(i, u); ++i) {
              if (u.pm < 128 && (u.pm & 31) != 0) {
                  for (int k = 0; k < 11; ++k) { const int e = tid + 512 * k; const int r = e >= DFF ? 1 : 0; const int ch = e - r * DFF;
                      const float g0 = HEADG[((size_t)u.pm * 2) * DFF + ch], g1 = HEADG[((size_t)u.pm * 2 + 1) * DFF + ch];
                      const float t0 = TAIL[((size_t)(u.pm - 1) * 2) * DFF + ch], t1 = TAIL[((size_t)(u.pm - 1) * 2 + 1) * DFF + ch];
                      const float w0 = cw[ch], w1 = cw[DFF + ch], w2 = cw[2 * DFF + ch], bb = cb[ch];
                      const float gc = r == 0 ? (w2 * g0 + (w1 * t1 + (w0 * t0 + bb))) : (w2 * g1 + (w1 * g0 + (w0 * t1 + bb)));
                      const float v = HEADV[((size_t)u.pm * 2 + r) * DFF + ch];
                      HID[((size_t)u.pm * 256 + r) * DFF + ch] = (bf16)f2bf(pg8::gelu_tanh(gc) * v); }
              }
          }
          VM_WAIT(); __syncthreads();
        }
        pg8::EpiDown E{out};
        pg8::gemm_phase<pg8::EpiDown, pg8::StaticOrder, true, true>(ldsl + RING_OFF, g, S, E);
        if (BOTH(5)) GRID_BAR();
    }

    if (IN(6)) {
        f32x4 gv[4];
#pragma unroll
        for (int j = 0; j < 4; ++j) gv[j] = *(const f32x4*)(args.in[21] + 4 * lane + 256 * j);
        for (int m = gw; m < M; m += NGW) {
            float* xrow = out + (size_t)m * D;
            f32x4 v[4]; float s = 0.f;
#pragma unroll
            for (int j = 0; j < 4; ++j) { v[j] = *(const f32x4*)(xrow + 4 * lane + 256 * j); s += (v[j][0] * v[j][0] + v[j][1] * v[j][1]) + (v[j][2] * v[j][2] + v[j][3] * v[j][3]); }
            const float rstd = __builtin_amdgcn_rsqf(wave_sum(s) * (1.0f / D) + EPS);
#pragma unroll
            for (int j = 0; j < 4; ++j) *(f32x4*)(xrow + 4 * lane + 256 * j) = v[j] * rstd * gv[j];
        }
        const int gt = vcu * 512 + tid;
        if (gt < 4 * 2 * DFF) { const int b = gt / (2 * DFF), rem = gt % (2 * DFF); out[O_FFN_P + gt] = TAIL[((size_t)(32 * b + 31) * 2) * DFF + rem]; }
    }
#undef IN
#undef BOTH
#undef GRID_BAR
}

extern "C" void kernel_launch(void* const* d_in, const int* in_sizes, int n_in, void* d_out, int out_size, void* d_ws, size_t ws_size, hipStream_t stream) {
    static int grid = 0;
    if (grid == 0) {
        if (n_in != 22 || in_sizes[0] != MP * D || (size_t)out_size != O_END || ws_size < WS_END) { fprintf(stderr, "kernel_launch: unexpected problem: n_in %d in0 %d out %d ws %zu (need %zu)\n", n_in, n_in > 0 ? in_sizes[0] : -1, out_size, ws_size, (size_t)WS_END); grid = -1; return; }
        int dev = 0, cus = 0, per_cu = 0;
        if (hipGetDevice(&dev) != hipSuccess || hipDeviceGetAttribute(&cus, hipDeviceAttributeMultiprocessorCount, dev) != hipSuccess) { grid = -1; return; }
        if (hipFuncSetAttribute((const void*)fwd_kernel, hipFuncAttributeMaxDynamicSharedMemorySize, LDS_BYTES) != hipSuccess) { fprintf(stderr, "kernel_launch: hipFuncSetAttribute failed\n"); grid = -1; return; }
        if (hipOccupancyMaxActiveBlocksPerMultiprocessor(&per_cu, (const void*)fwd_kernel, 512, LDS_BYTES) != hipSuccess || per_cu < 1) fprintf(stderr, "kernel_launch: occupancy query reports %d\n", per_cu);
        (void)hipGetLastError();
        grid = cus;
    }
    if (grid < 0) return;
    if (hipMemsetAsync((char*)d_ws + WS_CTL, 0, CTL_ZERO_BYTES, stream) != hipSuccess) { fprintf(stderr, "kernel_launch: memset failed\n"); return; }
    Args a{};
    for (int i = 0; i < 22; ++i) a.in[i] = (const float*)d_in[i];
    a.out = (float*)d_out; a.ws = (unsigned char*)d_ws;
    for (int li = 0; li < MK_N_LAUNCHES; ++li) {
        if (MK_N_LAUNCHES == N_PHASES) { a.ph_lo = li; a.ph_hi = li + 1; a.li = 0; }
        else { a.ph_lo = li * N_PHASES / MK_N_LAUNCHES; a.ph_hi = (li + 1) * N_PHASES / MK_N_LAUNCHES; a.li = li; }
        hipLaunchKernelGGL(fwd_kernel, dim3(grid), dim3(512), LDS_BYTES, stream, a);
        const hipError_t le = hipPeekAtLastError();
        if (le != hipSuccess) { fprintf(stderr, "kernel_launch: launch %d failed: %s\n", li, hipGetErrorName(le)); break; }
    }
}
```
